# Optimizing an MI355X kernel written in HIP

```python
import math
import jax, jax.numpy as jnp
from jax import lax
import numpy as np

D_MODEL = 1024
BATCH = 4
SEQ = 8192
DEPTH = 1

HEAD_DIM = 64
N_Q_HEADS = 8
N_KV_HEADS = 2
Q_PER_KV = N_Q_HEADS // N_KV_HEADS
ATTN_WIDTH = N_Q_HEADS * HEAD_DIM
KV_WIDTH = N_KV_HEADS * HEAD_DIM
WINDOW = 128
ATTN_BLOCK = 128
ROPE_THETA = 10000.0
SSM_HEADS = 8
SSM_HEAD_DIM = 64
SSM_WIDTH = SSM_HEADS * SSM_HEAD_DIM
SSM_GROUPS = 2
HEADS_PER_GROUP = SSM_HEADS // SSM_GROUPS
D_STATE = 128
CONV_WIDTH = 4
CHUNK = 128
CONV_CH = SSM_WIDTH + 2 * SSM_GROUPS * D_STATE
MIX_WIDTH = ATTN_WIDTH + SSM_WIDTH
IN_PROJ = ATTN_WIDTH + 2 * KV_WIDTH + SSM_WIDTH + CONV_CH + SSM_HEADS
D_FF = -(-8 * D_MODEL // (3 * 256)) * 256
N_MOD = 6
EPS = 1e-6

kernel_name = "hymba_swa_sink_ssd_adaln_layer"


def rmsnorm(x, w):
    xf = x.astype(jnp.float32)
    y = xf * lax.rsqrt(jnp.mean(xf * xf, axis=-1, keepdims=True) + EPS)
    return (y * w.astype(jnp.float32)).astype(x.dtype)


def modulate(h, shift, scale):
    return h * (1.0 + scale[:, None, :]) + shift[:, None, :]


def rope(t, positions):
    half = HEAD_DIM // 2
    inv_freq = ROPE_THETA ** (-jnp.arange(half, dtype=jnp.float32) / half)
    ang = positions.astype(jnp.float32)[..., None] * inv_freq
    cos = jnp.cos(ang)[:, :, None, :]
    sin = jnp.sin(ang)[:, :, None, :]
    tf = t.astype(jnp.float32)
    t1, t2 = tf[..., :half], tf[..., half:]
    out = jnp.concatenate([t1 * cos - t2 * sin, t2 * cos + t1 * sin], axis=-1)
    return out.astype(t.dtype)


def sliding_window_attention(q, k, v, sinks):
    b, s = q.shape[0], q.shape[1]
    nb = s // ATTN_BLOCK
    qb = q.reshape(b, nb, ATTN_BLOCK, N_KV_HEADS, Q_PER_KV, HEAD_DIM)

    def band(t):
        tb = t.reshape(b, nb, ATTN_BLOCK, N_KV_HEADS, HEAD_DIM)
        prev = jnp.pad(tb, ((0, 0), (1, 0), (0, 0), (0, 0), (0, 0)))[:, :-1]
        return jnp.concatenate([prev, tb], axis=2)

    kb, vb = band(k), band(v)
    scores = jnp.einsum('bnqhgd,bnkhd->bnhgqk', qb, kb).astype(jnp.float32)
    scores = scores * (1.0 / math.sqrt(HEAD_DIM))
    blk = jnp.arange(nb)[:, None] * ATTN_BLOCK
    qpos = blk + jnp.arange(ATTN_BLOCK)[None, :]
    kpos = blk - ATTN_BLOCK + jnp.arange(2 * ATTN_BLOCK)[None, :]
    diff = qpos[:, :, None] - kpos[:, None, :]
    mask = (diff >= 0) & (diff < WINDOW) & (kpos[:, None, :] >= 0)
    scores = jnp.where(mask[None, :, None, None], scores, -jnp.inf)
    sink = sinks.astype(jnp.float32).reshape(N_KV_HEADS, Q_PER_KV)[None, None, :, :, None, None]
    m = jnp.maximum(jnp.max(scores, axis=-1, keepdims=True), sink)
    p = jnp.exp(scores - m)
    denom = jnp.sum(p, axis=-1, keepdims=True) + jnp.exp(sink - m)
    probs = (p / denom).astype(v.dtype)
    out = jnp.einsum('bnhgqk,bnkhd->bnqhgd', probs, vb)
    return out.reshape(b, s, ATTN_WIDTH)


def causal_depthwise_conv(u, w, bias):
    out = lax.conv_general_dilated(
        u, w[:, None, :].astype(u.dtype), window_strides=(1,),
        padding=[(CONV_WIDTH - 1, 0)], dimension_numbers=('NWC', 'WIO', 'NWC'),
        feature_group_count=u.shape[-1])
    return out + bias.astype(u.dtype)


def ssd_chunked_scan(xs, dt, A, Bm, Cm, d_skip):
    b, s = xs.shape[0], xs.shape[1]
    nc = s // CHUNK
    xf = xs.astype(jnp.float32)
    xdt = (xf * dt[..., None]).reshape(b, nc, CHUNK, SSM_GROUPS, HEADS_PER_GROUP, SSM_HEAD_DIM)
    a = (dt * A).reshape(b, nc, CHUNK, SSM_GROUPS, HEADS_PER_GROUP)
    a_cs = jnp.cumsum(a, axis=2)
    Bc = Bm.astype(jnp.float32).reshape(b, nc, CHUNK, SSM_GROUPS, D_STATE)
    Cc = Cm.astype(jnp.float32).reshape(b, nc, CHUNK, SSM_GROUPS, D_STATE)
    causal = jnp.tril(jnp.ones((CHUNK, CHUNK), dtype=bool))[None, None, :, :, None, None]
    seg = a_cs[:, :, :, None] - a_cs[:, :, None, :]
    decay = jnp.exp(jnp.where(causal, seg, -jnp.inf))
    cb = jnp.einsum('bclgn,bcsgn->bclsg', Cc, Bc)
    y_diag = jnp.einsum('bclsg,bclsgj,bcsgjp->bclgjp', cb, decay, xdt)
    decay_to_end = jnp.exp(a_cs[:, :, -1:] - a_cs)
    states = jnp.einsum('bclgn,bclgj,bclgjp->bcgjpn', Bc, decay_to_end, xdt)
    chunk_decay = jnp.exp(a_cs[:, :, -1])

    def step(h, inp):
        st, dec = inp
        return h * dec[..., None, None] + st, h

    init = jnp.zeros((b, SSM_GROUPS, HEADS_PER_GROUP, SSM_HEAD_DIM, D_STATE), jnp.float32)
    _, prev = lax.scan(step, init, (jnp.moveaxis(states, 1, 0), jnp.moveaxis(chunk_decay, 1, 0)))
    prev = jnp.moveaxis(prev, 0, 1)
    y_off = jnp.einsum('bclgn,bcgjpn,bclgj->bclgjp', Cc, prev, jnp.exp(a_cs))
    y = (y_diag + y_off).reshape(b, s, SSM_HEADS, SSM_HEAD_DIM)
    return y + xf * d_skip.astype(jnp.float32)[:, None]


def hybrid_mixer(h, positions, w_in, conv_w, conv_b, dt_bias, a_log, d_skip, sinks, ssm_norm_w, w_out):
    b, s = h.shape[0], h.shape[1]
    proj = h @ w_in
    o1 = ATTN_WIDTH
    o2 = o1 + KV_WIDTH
    o3 = o2 + KV_WIDTH
    o4 = o3 + SSM_WIDTH
    o5 = o4 + CONV_CH
    q, k, v, z, xbc, dt_raw = jnp.split(proj, [o1, o2, o3, o4, o5], axis=-1)
    q = rope(q.reshape(b, s, N_Q_HEADS, HEAD_DIM), positions)
    k = rope(k.reshape(b, s, N_KV_HEADS, HEAD_DIM), positions)
    v = v.reshape(b, s, N_KV_HEADS, HEAD_DIM)
    attn = sliding_window_attention(q, k, v, sinks)
    xbc = jax.nn.silu(causal_depthwise_conv(xbc, conv_w, conv_b))
    xs, Bm, Cm = jnp.split(xbc, [SSM_WIDTH, SSM_WIDTH + SSM_GROUPS * D_STATE], axis=-1)
    xs = xs.reshape(b, s, SSM_HEADS, SSM_HEAD_DIM)
    Bm = Bm.reshape(b, s, SSM_GROUPS, D_STATE)
    Cm = Cm.reshape(b, s, SSM_GROUPS, D_STATE)
    dt = jax.nn.softplus(dt_raw.astype(jnp.float32) + dt_bias.astype(jnp.float32))
    A = -jnp.exp(a_log.astype(jnp.float32))
    y = ssd_chunked_scan(xs, dt, A, Bm, Cm, d_skip).reshape(b, s, SSM_WIDTH)
    y = y * jax.nn.silu(z.astype(jnp.float32))
    yg = y.reshape(b, s, SSM_GROUPS, SSM_WIDTH // SSM_GROUPS)
    yg = yg * lax.rsqrt(jnp.mean(yg * yg, axis=-1, keepdims=True) + EPS)
    y = (yg.reshape(b, s, SSM_WIDTH) * ssm_norm_w.astype(jnp.float32)).astype(h.dtype)
    return jnp.concatenate([attn.astype(h.dtype), y], axis=-1) @ w_out


def swiglu(h, w_gate_up, w_down):
    gu = h @ w_gate_up
    g, u = jnp.split(gu, 2, axis=-1)
    return (jax.nn.silu(g) * u) @ w_down


def setup_inputs(seed: int = 0) -> dict:
    key = jax.random.key(seed)
    ks = jax.random.split(key, 20)
    f32 = jnp.float32
    L = DEPTH
    x = jax.random.normal(ks[0], (BATCH, SEQ, D_MODEL), f32)
    c = jax.random.normal(ks[1], (BATCH, D_MODEL), f32)
    offset = jax.random.randint(ks[2], (BATCH, 1), 0, 4096, dtype=jnp.int32)
    positions = (jnp.arange(SEQ, dtype=jnp.int32)[None, :] + offset).astype(jnp.int32)
    w_ada = jax.random.normal(ks[3], (L, D_MODEL, N_MOD * D_MODEL), f32) * (0.5 * D_MODEL ** -0.5)
    b_ada = 0.01 * jax.random.normal(ks[4], (L, N_MOD * D_MODEL), f32)
    norm1_w = 1.0 + 0.02 * jax.random.normal(ks[5], (L, D_MODEL), f32)
    w_in = jax.random.normal(ks[6], (L, D_MODEL, IN_PROJ), f32) * D_MODEL ** -0.5
    conv_w = jax.random.normal(ks[7], (L, CONV_WIDTH, CONV_CH), f32) * CONV_WIDTH ** -0.5
    conv_b = 0.01 * jax.random.normal(ks[8], (L, CONV_CH), f32)
    dt0 = jnp.exp(jax.random.uniform(ks[9], (L, SSM_HEADS), f32, math.log(1e-3), math.log(1e-1)))
    dt_bias = dt0 + jnp.log(-jnp.expm1(-dt0))
    a_log = jnp.log(jax.random.uniform(ks[10], (L, SSM_HEADS), f32, 1.0, 16.0))
    d_skip = 1.0 + 0.1 * jax.random.normal(ks[11], (L, SSM_HEADS), f32)
    attn_sinks = jax.random.normal(ks[12], (L, N_Q_HEADS), f32)
    ssm_norm_w = 1.0 + 0.02 * jax.random.normal(ks[13], (L, SSM_WIDTH), f32)
    w_out = jax.random.normal(ks[14], (L, MIX_WIDTH, D_MODEL), f32) * MIX_WIDTH ** -0.5
    norm2_w = 1.0 + 0.02 * jax.random.normal(ks[15], (L, D_MODEL), f32)
    w_gate_up = jax.random.normal(ks[16], (L, D_MODEL, 2 * D_FF), f32) * D_MODEL ** -0.5
    w_down = jax.random.normal(ks[17], (L, D_FF, D_MODEL), f32) * D_FF ** -0.5
    final_norm_w = 1.0 + 0.02 * jax.random.normal(ks[18], (D_MODEL,), f32)
    return {"x": x, "c": c, "positions": positions, "w_ada": w_ada, "b_ada": b_ada,
            "norm1_w": norm1_w, "w_in": w_in, "conv_w": conv_w, "conv_b": conv_b,
            "dt_bias": dt_bias, "a_log": a_log, "d_skip": d_skip, "attn_sinks": attn_sinks,
            "ssm_norm_w": ssm_norm_w, "w_out": w_out, "norm2_w": norm2_w,
            "w_gate_up": w_gate_up, "w_down": w_down, "final_norm_w": final_norm_w}


def reference(x, c, positions, w_ada, b_ada, norm1_w, w_in, conv_w, conv_b, dt_bias, a_log,
              d_skip, attn_sinks, ssm_norm_w, w_out, norm2_w, w_gate_up, w_down, final_norm_w):
    for layer in range(DEPTH):
        mod = jax.nn.silu(c) @ w_ada[layer] + b_ada[layer]
        shift1, scale1, gate1, shift2, scale2, gate2 = jnp.split(mod, N_MOD, axis=-1)
        h = modulate(rmsnorm(x, norm1_w[layer]), shift1, scale1)
        x = x + gate1[:, None, :] * hybrid_mixer(
            h, positions, w_in[layer], conv_w[layer], conv_b[layer], dt_bias[layer],
            a_log[layer], d_skip[layer], attn_sinks[layer], ssm_norm_w[layer], w_out[layer])
        h = modulate(rmsnorm(x, norm2_w[layer]), shift2, scale2)
        x = x + gate2[:, None, :] * swiglu(h, w_gate_up[layer], w_down[layer])
    return rmsnorm(x, final_norm_w)
```

```cpp
#include <hip/hip_runtime.h>
#include <cstdio>
#include <cstdint>
#include <cmath>
namespace nv {
constexpr int D = 1024, SEQ = 8192, NBATCH = 4, INP = 2312, DFF = 2816;
constexpr float EPS = 1e-6f;

__device__ __forceinline__ float silu_f(float v) { return v / (1.f + expf(-v)); }
__device__ __forceinline__ float softplus_f(float v) { return v > 20.f ? v : log1pf(expf(v)); }

__global__ void k_mod(const float* c, const float* w_ada, const float* b_ada, float* mod) {
    const int j = blockIdx.x * 256 + threadIdx.x, b = blockIdx.y;
    float acc = 0.f;
    for (int k = 0; k < D; ++k) acc += silu_f(c[b * D + k]) * w_ada[(size_t)k * 6144 + j];
    mod[b * 6144 + j] = acc + b_ada[j];
}

__device__ __forceinline__ float block_sum256(float v, float* red) {
#pragma unroll
    for (int o = 32; o > 0; o >>= 1) v += __shfl_xor(v, o);
    __syncthreads();
    if ((threadIdx.x & 63) == 0) red[threadIdx.x >> 6] = v;
    __syncthreads();
    return red[0] + red[1] + red[2] + red[3];
}

__global__ void k_norm_mod(const float* x, const float* w, const float* shift, const float* scale, float* out) {
    __shared__ float red[4];
    const size_t r = blockIdx.x; const float* xr = x + r * D; float v[4]; float s = 0.f;
#pragma unroll
    for (int i = 0; i < 4; ++i) { v[i] = xr[threadIdx.x + 256 * i]; s += v[i] * v[i]; }
    const float tot = block_sum256(s, red); const float rstd = rsqrtf(tot / D + EPS);
#pragma unroll
    for (int i = 0; i < 4; ++i) { const int cidx = threadIdx.x + 256 * i; out[r * D + cidx] = v[i] * rstd * w[cidx] * (1.f + scale[cidx]) + shift[cidx]; }
}

template <int MODE>
__global__ void __launch_bounds__(256) k_gemm(const float* A, int lda, const float* B, int ldb, float* C, int ldc, int M, int N, int K, int off2) {
    __shared__ float As[16][65], Bs[16][65], B2s[MODE ? 16 : 1][65];
    const int tx = threadIdx.x & 15, ty = threadIdx.x >> 4; const int m0 = blockIdx.y * 64, n0 = blockIdx.x * 64;
    float acc[4][4] = {}, acc2[4][4] = {};
    for (int k0 = 0; k0 < K; k0 += 16) {
        for (int i = threadIdx.x; i < 64 * 16; i += 256) { const int mm = i >> 4, kk = i & 15; As[kk][mm] = (m0 + mm < M) ? A[(size_t)(m0 + mm) * lda + k0 + kk] : 0.f; }
        for (int i = threadIdx.x; i < 16 * 64; i += 256) { const int kk = i >> 6, nn = i & 63; Bs[kk][nn] = (n0 + nn < N) ? B[(size_t)(k0 + kk) * ldb + n0 + nn] : 0.f;
            if (MODE) B2s[kk][nn] = (n0 + nn < N) ? B[(size_t)(k0 + kk) * ldb + n0 + nn + off2] : 0.f; }
        __syncthreads();
#pragma unroll
        for (int kk = 0; kk < 16; ++kk) {
            float a[4], b[4], b2[4];
#pragma unroll
            for (int i = 0; i < 4; ++i) { a[i] = As[kk][ty * 4 + i]; b[i] = Bs[kk][tx * 4 + i]; if (MODE) b2[i] = B2s[kk][tx * 4 + i]; }
#pragma unroll
            for (int i = 0; i < 4; ++i)
#pragma unroll
                for (int j = 0; j < 4; ++j) { acc[i][j] += a[i] * b[j]; if (MODE) acc2[i][j] += a[i] * b2[j]; }
        }
        __syncthreads();
    }
#pragma unroll
    for (int i = 0; i < 4; ++i)
#pragma unroll
        for (int j = 0; j < 4; ++j) { const int m = m0 + ty * 4 + i, n = n0 + tx * 4 + j;
            if (m < M && n < N) C[(size_t)m * ldc + n] = MODE ? silu_f(acc[i][j]) * acc2[i][j] : acc[i][j]; }
}

__global__ void k_rope(float* proj, const int* pos, int ntok) {
    const size_t gid = (size_t)blockIdx.x * 256 + threadIdx.x; if (gid >= (size_t)ntok * 320) return;
    const int i = gid & 31, hh = (gid >> 5) % 10; const size_t t = gid / 320;
    float* p = proj + t * INP + hh * 64;
    const float inv = powf(10000.f, -(float)i / 32.f), ang = (float)pos[t] * inv, c = cosf(ang), s = sinf(ang);
    const float t1 = p[i], t2 = p[i + 32];
    p[i] = t1 * c - t2 * s; p[i + 32] = t2 * c + t1 * s;
}

__global__ void k_attn(const float* proj, const float* sinks, float* mix) {
    const int s = blockIdx.x, h = blockIdx.y, lane = threadIdx.x, g = h >> 2;
    const float* q = proj + (size_t)s * INP + h * 64;
    float sc[2];
#pragma unroll
    for (int u = 0; u < 2; ++u) { const int j = s - lane - 64 * u; float d = -INFINITY;
        if (j >= 0) { const float* k = proj + (size_t)j * INP + 512 + g * 64; d = 0.f; for (int e = 0; e < 64; ++e) d += q[e] * k[e]; d *= 0.125f; }
        sc[u] = d; }
    const float sink = sinks[h];
    float m = fmaxf(fmaxf(sc[0], sc[1]), sink);
#pragma unroll
    for (int o = 32; o > 0; o >>= 1) m = fmaxf(m, __shfl_xor(m, o));
    const float p0 = (sc[0] == -INFINITY) ? 0.f : expf(sc[0] - m), p1 = (sc[1] == -INFINITY) ? 0.f : expf(sc[1] - m);
    float den = p0 + p1;
#pragma unroll
    for (int o = 32; o > 0; o >>= 1) den += __shfl_xor(den, o);
    den += expf(sink - m);
    float o = 0.f;
    for (int jj = 0; jj < 64; ++jj) {
        const float a = __shfl(p0, jj), b = __shfl(p1, jj); const int j0 = s - jj, j1 = s - 64 - jj;
        if (j0 >= 0) o += a * proj[(size_t)j0 * INP + 640 + g * 64 + lane];
        if (j1 >= 0) o += b * proj[(size_t)j1 * INP + 640 + g * 64 + lane];
    }
    mix[(size_t)s * D + h * 64 + lane] = o / den;
}

__global__ void k_conv(const float* proj, const float* cw, const float* cb, float* xc, int ntok) {
    const size_t gid = (size_t)blockIdx.x * 256 + threadIdx.x; if (gid >= (size_t)ntok * 1024) return;
    const int ch = gid & 1023; const int s = gid >> 10; float a = cb[ch];
#pragma unroll
    for (int k = 0; k < 4; ++k) { const int sp = s - 3 + k; if (sp >= 0) a += cw[k * 1024 + ch] * proj[(size_t)sp * INP + 1280 + ch]; }
    xc[gid] = silu_f(a);
}

__global__ void __launch_bounds__(256) k_ssd(const float* proj, const float* xc, const float* dt_bias, const float* a_log, const float* d_skip, float* y, int ntok) {
    const int h = blockIdx.x, g = h >> 2, p = threadIdx.x >> 2, nq = threadIdx.x & 3;
    float st[32];
#pragma unroll
    for (int i = 0; i < 32; ++i) st[i] = 0.f;
    const float A = -expf(a_log[h]), dsk = d_skip[h], dtb = dt_bias[h];
    for (int s = 0; s < ntok; ++s) {
        const float dt = softplus_f(proj[(size_t)s * INP + 2304 + h] + dtb), dec = expf(dt * A);
        const float xs = xc[(size_t)s * 1024 + h * 64 + p], xdt = xs * dt;
        const float* Bp = xc + (size_t)s * 1024 + 512 + g * 128 + nq * 32; const float* Cp = xc + (size_t)s * 1024 + 768 + g * 128 + nq * 32;
        float acc = 0.f;
#pragma unroll
        for (int i = 0; i < 32; ++i) { st[i] = st[i] * dec + Bp[i] * xdt; acc += Cp[i] * st[i]; }
        acc += __shfl_xor(acc, 1); acc += __shfl_xor(acc, 2);
        if (nq == 0) y[(size_t)s * 512 + h * 64 + p] = acc + xs * dsk;
    }
}

__global__ void k_ygate(const float* proj, const float* y, const float* nw, float* mix) {
    __shared__ float red[4];
    const size_t s = blockIdx.x; float v[2]; float tot[2];
#pragma unroll
    for (int u = 0; u < 2; ++u) { const int ch = threadIdx.x + 256 * u; v[u] = y[s * 512 + ch] * silu_f(proj[s * INP + 768 + ch]); }
    tot[0] = block_sum256(v[0] * v[0], red); tot[1] = block_sum256(v[1] * v[1], red);
#pragma unroll
    for (int u = 0; u < 2; ++u) { const int ch = threadIdx.x + 256 * u; mix[s * D + 512 + ch] = v[u] * rsqrtf(tot[u] / 256.f + EPS) * nw[ch]; }
}

__global__ void k_res_norm(const float* x, const float* mo, const float* gate, const float* w2, const float* shift2, const float* scale2, float* x1out, float* h2out) {
    __shared__ float red[4];
    const size_t r = blockIdx.x; float v[4]; float s = 0.f;
#pragma unroll
    for (int i = 0; i < 4; ++i) { const int cidx = threadIdx.x + 256 * i; v[i] = x[r * D + cidx] + gate[cidx] * mo[r * D + cidx]; s += v[i] * v[i]; x1out[r * D + cidx] = v[i]; }
    const float rstd = rsqrtf(block_sum256(s, red) / D + EPS);
#pragma unroll
    for (int i = 0; i < 4; ++i) { const int cidx = threadIdx.x + 256 * i; h2out[r * D + cidx] = v[i] * rstd * w2[cidx] * (1.f + scale2[cidx]) + shift2[cidx]; }
}
__global__ void k_final(float* x1out, const float* dn, const float* gate2, const float* wf) {
    __shared__ float red[4];
    const size_t r = blockIdx.x; float v[4]; float s = 0.f;
#pragma unroll
    for (int i = 0; i < 4; ++i) { const int cidx = threadIdx.x + 256 * i; v[i] = x1out[r * D + cidx] + gate2[cidx] * dn[r * D + cidx]; s += v[i] * v[i]; }
    const float rstd = rsqrtf(block_sum256(s, red) / D + EPS);
#pragma unroll
    for (int i = 0; i < 4; ++i) { const int cidx = threadIdx.x + 256 * i; x1out[r * D + cidx] = v[i] * rstd * wf[cidx]; }
}

struct Bufs {
    float *mod, *hbuf, *proj, *xc, *y, *mix, *mo, *act;
};
__host__ inline size_t slab_floats(int ntok) { return (size_t)24576 + (size_t)ntok * (1024 + (INP + 1024 > DFF ? INP + 1024 : DFF) + 512 + 1024 + 1024); }
__host__ inline Bufs carve(float* base, int ntok) {
    Bufs B; B.mod = base; base += 24576; B.hbuf = base; base += (size_t)ntok * 1024;
    B.proj = base; B.xc = base + (size_t)ntok * INP; B.act = B.proj; base += (size_t)ntok * (INP + 1024 > DFF ? INP + 1024 : DFF);
    B.y = base; base += (size_t)ntok * 512; B.mix = base; base += (size_t)ntok * 1024; B.mo = base; return B;
}
__host__ inline void run_slab(void* const* d_in, int b, int ntok, const Bufs& B, float* out, hipStream_t st, bool do_mod) {
    const float* x = (const float*)d_in[0] + (size_t)b * SEQ * D; const float* c = (const float*)d_in[1]; const int* pos = (const int*)d_in[2] + (size_t)b * SEQ;
    const float *w_ada = (const float*)d_in[3], *b_ada = (const float*)d_in[4], *norm1_w = (const float*)d_in[5], *w_in = (const float*)d_in[6], *conv_w = (const float*)d_in[7], *conv_b = (const float*)d_in[8];
    const float *dt_bias = (const float*)d_in[9], *a_log = (const float*)d_in[10], *d_skip = (const float*)d_in[11], *sinks = (const float*)d_in[12], *ssm_nw = (const float*)d_in[13], *w_out = (const float*)d_in[14];
    const float *norm2_w = (const float*)d_in[15], *w_gu = (const float*)d_in[16], *w_down = (const float*)d_in[17], *wf = (const float*)d_in[18];
    if (do_mod) k_mod<<<dim3(24, 4), 256, 0, st>>>(c, w_ada, b_ada, B.mod);
    const float* mod = B.mod + b * 6144;
    k_norm_mod<<<ntok, 256, 0, st>>>(x, norm1_w, mod, mod + 1024, B.hbuf);
    k_gemm<0><<<dim3((INP + 63) / 64, ntok / 64), 256, 0, st>>>(B.hbuf, 1024, w_in, INP, B.proj, INP, ntok, INP, 1024, 0);
    k_rope<<<(ntok * 320 + 255) / 256, 256, 0, st>>>(B.proj, pos, ntok);
    k_attn<<<dim3(ntok, 8), 64, 0, st>>>(B.proj, sinks, B.mix);
    k_conv<<<ntok * 4, 256, 0, st>>>(B.proj, conv_w, conv_b, B.xc, ntok);
    k_ssd<<<8, 256, 0, st>>>(B.proj, B.xc, dt_bias, a_log, d_skip, B.y, ntok);
    k_ygate<<<ntok, 256, 0, st>>>(B.proj, B.y, ssm_nw, B.mix);
    k_gemm<0><<<dim3(16, ntok / 64), 256, 0, st>>>(B.mix, 1024, w_out, 1024, B.mo, 1024, ntok, 1024, 1024, 0);
    k_res_norm<<<ntok, 256, 0, st>>>(x, B.mo, mod + 2048, norm2_w, mod + 3072, mod + 4096, out, B.hbuf);
    k_gemm<1><<<dim3(DFF / 64, ntok / 64), 256, 0, st>>>(B.hbuf, 1024, w_gu, 2 * DFF, B.act, DFF, ntok, DFF, 1024, DFF);
    k_gemm<0><<<dim3(16, ntok / 64), 256, 0, st>>>(B.act, DFF, w_down, 1024, B.mo, 1024, ntok, 1024, DFF, 0);
    k_final<<<ntok, 256, 0, st>>>(out, B.mo, mod + 5120, wf);
}
}
extern "C" void kernel_launch(void* const* d_in, const int* in_sizes, int n_in, void* d_out, int out_size, void* d_ws, size_t ws_size, hipStream_t stream) {
    (void)in_sizes; (void)n_in; (void)out_size; (void)ws_size;
    nv::Bufs B = nv::carve((float*)d_ws, nv::SEQ);
    for (int b = 0; b < nv::NBATCH; ++b) nv::run_slab(d_in, b, nv::SEQ, B, (float*)d_out + (size_t)b * nv::SEQ * nv::D, stream, b == 0);
}
```

```cpp
#include <hip/hip_runtime.h>
#include <cstdio>
#include <cstdint>
#include <cmath>
namespace pg8 {
#define PG8_LAS __attribute__((address_space(3)))
typedef unsigned short bf16_t;
typedef short bf16x8 __attribute__((ext_vector_type(8)));
typedef float f32x4 __attribute__((ext_vector_type(4)));
typedef unsigned u32x4 __attribute__((ext_vector_type(4)));
constexpr int BM = 256, BK = 64, HALF = 128, HTB = HALF * BK * 2  , STAGE_BYTES = 8 * HTB, NXCD = 8, WGM = 8;

__host__ __device__ __forceinline__ int lds_byte(int r, int c) { const int st = (r >> 4) * 2 + (c >> 5), rr = r & 15, cc = c & 31, ob = rr * 64 + cc * 2; return st * 1024 + (ob ^ (((ob >> 9) & 1) << 5)); }
__host__ __device__ __forceinline__ void stage_rc(int b, int& R, int& C) { const int st = b / 1024, sb = b % 1024, swz = sb ^ (((sb >> 9) & 1) << 5); R = (st >> 1) * 16 + swz / 64; C = (st & 1) * 32 + (swz % 64) / 2; }
__host__ __device__ __forceinline__ int perm32(int rho) { const int n = rho >> 4, i = rho & 15; return 8 * (i >> 2) + 4 * n + (i & 3); }

struct Unit { int pm, pn; };
struct Gemm { const bf16_t* A; const bf16_t* Bt; int M, N, K; };

struct StaticOrder {
    int nM, nN, nwg, G, c;
    __host__ __device__ void init(int M, int N, int G_, int c_) { nM = M / BM; nN = N / BM; nwg = nM * nN; G = G_; c = c_; }
    __host__ __device__ bool next(int i, Unit& u) const {
        const long L = (long)i * G + c; if (L >= nwg) return false;
        int wgid = (int)L; { const int q = nwg / NXCD, r = nwg % NXCD, xcd = wgid % NXCD, off = wgid / NXCD; wgid = (xcd < r ? xcd * (q + 1) : r * (q + 1) + (xcd - r) * q) + off; }
        const int nig = WGM * nN, gid = wgid / nig, fm = gid * WGM, gsz = (nM - fm) < WGM ? (nM - fm) : WGM;
        u.pm = fm + ((wgid % nig) % gsz); u.pn = (wgid % nig) / gsz; return true;
    }
    __device__ __forceinline__ void a_ready(const Unit&) const {}
    __device__ __forceinline__ void done(const Unit&) const {}
};

__device__ __forceinline__ unsigned cvt_pk_bf16(float lo, float hi) { unsigned r; asm volatile("v_cvt_pk_bf16_f32 %0, %1, %2" : "=v"(r) : "v"(lo), "v"(hi)); return r; }
typedef float f32x2 __attribute__((ext_vector_type(2)));
typedef unsigned u32x2 __attribute__((ext_vector_type(2)));
__device__ __forceinline__ float silu_fast(float v) { return v * __builtin_amdgcn_rcpf(1.f + __builtin_amdgcn_exp2f(-1.4426950408889634f * v)); }
__device__ __forceinline__ f32x4 silu4(f32x4 v) { return (f32x4){silu_fast(v[0]), silu_fast(v[1]), silu_fast(v[2]), silu_fast(v[3])}; }
__device__ __forceinline__ u32x2 pack4(f32x4 v) { u32x2 w; w.x = cvt_pk_bf16(v[0], v[1]); w.y = cvt_pk_bf16(v[2], v[3]); return w; }

struct EpiInProj {
    static constexpr bool PERM = false, AFTER_DRAIN = false;
    bf16_t* P; const float* rope; float qscale;
    __device__ __forceinline__ void operator()(const f32x4 (&acc)[2][2][4][2], const Unit& u, int wr, int wc, int fr, int fq) const {
        const int pn = u.pn, lc0 = pn * 256 + 64 * (wc >> 1) + 16 * (wc & 1) + 4 * fq, ri = 16 * (wc & 1) + 4 * fq;
#pragma unroll
        for (int ai = 0; ai < 2; ++ai)
#pragma unroll
            for (int m = 0; m < 4; ++m) {
                const int row = u.pm * BM + ai * HALF + wr * 64 + m * 16 + fr;
                bf16_t* rowp = P + (size_t)row * 2304 + lc0;
                f32x4 c = (f32x4){0.f, 0.f, 0.f, 0.f}, s = c;
                if (pn <= 2) { c = *(const f32x4*)(rope + (size_t)row * 64 + ri); s = *(const f32x4*)(rope + (size_t)row * 64 + 32 + ri); }
#pragma unroll
                for (int bj = 0; bj < 2; ++bj) {
                    f32x4 v0 = acc[ai][bj][m][0], v1 = acc[ai][bj][m][1];
                    if (pn < 2 || (pn == 2 && bj == 0)) {
                        f32x4 o0 = v0 * c - v1 * s, o1 = v1 * c + v0 * s;
                        if (pn < 2) { o0 = o0 * qscale; o1 = o1 * qscale; }
                        v0 = o0; v1 = o1;
                    } else if (pn == 3 || pn == 4) { v0 = silu4(v0); v1 = silu4(v1); }
                    *(u32x2*)(rowp + bj * HALF) = pack4(v0); *(u32x2*)(rowp + bj * HALF + 32) = pack4(v1);
                }
            }
    }
};

template <bool WITH_A> struct EpiRes {
    static constexpr bool PERM = false, AFTER_DRAIN = false;
    const float* base; float* out; const float* mod; int gate_off; const float* w2; bf16_t* xa; float* ssq;
    __device__ __forceinline__ void operator()(const f32x4 (&acc)[2][2][4][2], const Unit& u, int wr, int wc, int fr, int fq) const {
        const int b = u.pm >> 5; const float* mb = mod + b * 6144; const int col0 = u.pn * BM + wc * 32 + 4 * fq;
        f32x4 gt[2][2], a2[2][2];
#pragma unroll
        for (int bj = 0; bj < 2; ++bj)
#pragma unroll
            for (int n = 0; n < 2; ++n) { const int c = col0 + bj * HALF + n * 16; gt[bj][n] = *(const f32x4*)(mb + gate_off + c);
                if (WITH_A) a2[bj][n] = *(const f32x4*)(w2 + c) * (*(const f32x4*)(mb + 4096 + c) + 1.0f); }
#pragma unroll
        for (int ai = 0; ai < 2; ++ai)
#pragma unroll
            for (int m = 0; m < 4; ++m) {
                const int row = u.pm * BM + ai * HALF + wr * 64 + m * 16 + fr; const size_t off = (size_t)row * 1024 + col0; float ss = 0.f;
#pragma unroll
                for (int bj = 0; bj < 2; ++bj)
#pragma unroll
                    for (int n = 0; n < 2; ++n) { const f32x4 bs = *(const f32x4*)(base + off + bj * HALF + n * 16); const f32x4 v = bs + gt[bj][n] * acc[ai][bj][m][n];
                        ss += (v[0] * v[0] + v[1] * v[1]) + (v[2] * v[2] + v[3] * v[3]);
                        *(f32x4*)(out + off + bj * HALF + n * 16) = v;
                        if (WITH_A) *(u32x2*)(xa + off + bj * HALF + n * 16) = pack4(v * a2[bj][n]); }
                ss += __shfl_xor(ss, 16); ss += __shfl_xor(ss, 32);
                if (fq == 0) ssq[(size_t)row * 16 + u.pn * 4 + wc] = ss;
            }
    }
};

struct EpiGU {
    static constexpr bool PERM = false, AFTER_DRAIN = false;
    bf16_t* act; const float* ssq; const float* bias2;
    __device__ __forceinline__ void operator()(const f32x4 (&acc)[2][2][4][2], const Unit& u, int wr, int wc, int fr, int fq) const {
        const int b = u.pm >> 5; const float* bb = bias2 + b * 5632 + u.pn * BM + wc * 32 + 4 * fq;
        f32x4 bv[2][2];
#pragma unroll
        for (int bj = 0; bj < 2; ++bj)
#pragma unroll
            for (int n = 0; n < 2; ++n) bv[bj][n] = *(const f32x4*)(bb + bj * HALF + n * 16);
#pragma unroll
        for (int ai = 0; ai < 2; ++ai)
#pragma unroll
            for (int m = 0; m < 4; ++m) {
                const int row = u.pm * BM + ai * HALF + wr * 64 + m * 16 + fr;
                const f32x4 pq = *(const f32x4*)(ssq + (size_t)row * 16 + 4 * fq); float s = (pq[0] + pq[1]) + (pq[2] + pq[3]);
                s += __shfl_xor(s, 16); s += __shfl_xor(s, 32);
                const float rstd = __builtin_amdgcn_rsqf(s * (1.0f / 1024.0f) + 1e-6f);
                u32x4 w;
#pragma unroll
                for (int bj = 0; bj < 2; ++bj) { const f32x4 g = acc[ai][bj][m][0] * rstd + bv[bj][0], uu = acc[ai][bj][m][1] * rstd + bv[bj][1]; const f32x4 a = silu4(g) * uu;
                    const u32x2 pk = pack4(a); if (bj == 0) { w.x = pk.x; w.y = pk.y; } else { w.z = pk.x; w.w = pk.y; } }
                *(u32x4*)(act + (size_t)row * 2816 + 128 * u.pn + 32 * wc + 8 * fq) = w;
            }
    }
};
template <class Epi, class Sched, bool ALIGN_EPI = false, bool SP2 = false>
__device__ __forceinline__ void gemm_phase(PG8_LAS unsigned char* lds, const Gemm g, const Sched& S, const Epi& E) {
    const int tid = threadIdx.x, wid = __builtin_amdgcn_readfirstlane(tid >> 6), lane = tid & 63, wr = wid >> 2, wc = wid & 3, fr = lane & 15, fq = lane >> 4;
    const int K = g.K, nt = K / BK;
    unsigned voffA[2], voffB[2];
#pragma unroll
    for (int i = 0; i < 2; ++i) { int R, C; stage_rc(tid * 16 + i * 8192, R, C); const int Rb = Epi::PERM ? ((R & ~31) + perm32(R & 31)) : R;
        voffA[i] = (unsigned)(R * K + C) * 2u; voffB[i] = (unsigned)(Rb * K + C) * 2u; }
    const size_t kstep = (size_t)(BK * 2);
    const size_t hstep = (size_t)HALF * K * 2;
    const size_t tstep = 2 * hstep;
    const unsigned ldsw = (unsigned)wid * 1024u;
    const int aoff = lds_byte(wr * 64 + fr, fq * 8), boff = lds_byte(wc * 32 + fr, fq * 8);
#define PG8_SA(b, h) (((b) * 2 + (h)) * HTB)
#define PG8_SB(b, h) ((4 + (b) * 2 + (h)) * HTB)
#define PG8_STAGE(bufoff, gbase, voff) do { _Pragma("unroll") for (int _i = 0; _i < 2; ++_i) \
        __builtin_amdgcn_global_load_lds((const unsigned*)((const char*)(gbase) + (voff)[_i]), (PG8_LAS unsigned*)(lds + (bufoff) + ldsw + _i * 8192), 16, 0, 0); } while (0)
#define PG8_LDA(dst, b, h) do { _Pragma("unroll") for (int m = 0; m < 4; ++m) _Pragma("unroll") for (int k = 0; k < 2; ++k) dst[m][k] = *(const PG8_LAS bf16x8*)(lds + PG8_SA(b, h) + aoff + m * 2048 + k * 1024); } while (0)
#define PG8_LDB(dst, b, h) do { _Pragma("unroll") for (int n = 0; n < 2; ++n) _Pragma("unroll") for (int k = 0; k < 2; ++k) dst[n][k] = *(const PG8_LAS bf16x8*)(lds + PG8_SB(b, h) + boff + n * 2048 + k * 1024); } while (0)
#define PG8_MMA(ai, bj, At, Bt) do { __builtin_amdgcn_s_setprio(1); _Pragma("unroll") for (int m = 0; m < 4; ++m) _Pragma("unroll") for (int n = 0; n < 2; ++n) _Pragma("unroll") for (int k = 0; k < 2; ++k) \
        acc[ai][bj][m][n] = __builtin_amdgcn_mfma_f32_16x16x32_bf16(Bt[n][k], At[m][k], acc[ai][bj][m][n], 0, 0, 0); __builtin_amdgcn_s_setprio(0); } while (0)
#define PG8_WAIT_V(n) asm volatile("s_waitcnt vmcnt(" #n ")" ::: "memory")
#define PG8_WAIT_L(n) asm volatile("s_waitcnt lgkmcnt(" #n ")" ::: "memory")
#define PG8_BAR __builtin_amdgcn_s_barrier()
#define PG8_SCHED __builtin_amdgcn_sched_barrier(0)
    Unit cur, nxt; int ui = 0;
    if (!S.next(0, cur)) return;
    f32x4 acc[2][2][4][2];
#pragma unroll
    for (int a = 0; a < 2; ++a)
#pragma unroll
        for (int b = 0; b < 2; ++b)
#pragma unroll
            for (int m = 0; m < 4; ++m)
#pragma unroll
                for (int n = 0; n < 2; ++n) acc[a][b][m][n] = (f32x4){0.f, 0.f, 0.f, 0.f};
    bf16x8 At[4][2], B0[2][2], B1[2][2];
    const char* cA = (const char*)g.A + (size_t)cur.pm * tstep; const char* cB = (const char*)g.Bt + (size_t)cur.pn * tstep;
    S.a_ready(cur);
    if constexpr (SP2) {
        PG8_STAGE(PG8_SB(0, 0), cB, voffB); PG8_STAGE(PG8_SB(0, 1), cB + hstep, voffB); PG8_STAGE(PG8_SA(0, 0), cA, voffA); PG8_STAGE(PG8_SA(0, 1), cA + hstep, voffA);
        if (wr == 1) PG8_BAR;
        PG8_WAIT_V(2); PG8_BAR;
        PG8_STAGE(PG8_SB(1, 0), cB + kstep, voffB); PG8_STAGE(PG8_SA(1, 0), cA + kstep, voffA); PG8_STAGE(PG8_SB(1, 1), cB + hstep + kstep, voffB);
        PG8_WAIT_V(6); PG8_BAR;
    } else {
        PG8_STAGE(PG8_SB(0, 0), cB, voffB); PG8_STAGE(PG8_SA(0, 0), cA, voffA); PG8_STAGE(PG8_SB(0, 1), cB + hstep, voffB); PG8_STAGE(PG8_SA(0, 1), cA + hstep, voffA);
        if (wr == 1) PG8_BAR;
        PG8_WAIT_V(4); PG8_BAR;
        PG8_STAGE(PG8_SB(1, 0), cB + kstep, voffB); PG8_STAGE(PG8_SA(1, 0), cA + kstep, voffA); PG8_STAGE(PG8_SB(1, 1), cB + hstep + kstep, voffB);
        PG8_WAIT_V(6); PG8_BAR;
    }
    for (;;) {
        const bool has_next = S.next(ui + 1, nxt);
        const char* nA = has_next ? (const char*)g.A + (size_t)nxt.pm * tstep : cA; const char* nB = has_next ? (const char*)g.Bt + (size_t)nxt.pn * tstep : cB;
        for (int t = 0; t < nt; t += 2) {
            const bool last = (t == nt - 2);
            const char* a1 = cA + (size_t)(t + 1) * kstep;
            const char* a2 = last ? nA : cA + (size_t)(t + 2) * kstep; const char* b2 = last ? nB : cB + (size_t)(t + 2) * kstep;
            const char* a3 = a2 + kstep; const char* b3 = b2 + kstep;
            if (last && has_next) S.a_ready(nxt);
            if constexpr (SP2) {
            PG8_LDB(B0, 0, 0); PG8_LDB(B1, 0, 1); PG8_SCHED; PG8_LDA(At, 0, 0); PG8_STAGE(PG8_SA(1, 1), a1 + hstep, voffA);
            PG8_WAIT_V(8); PG8_WAIT_L(0); PG8_BAR; PG8_MMA(0, 0, At, B0); PG8_MMA(0, 1, At, B1); PG8_BAR; PG8_SCHED;
            PG8_LDA(At, 0, 1); PG8_STAGE(PG8_SB(0, 0), b2, voffB); PG8_STAGE(PG8_SB(0, 1), b2 + hstep, voffB); PG8_STAGE(PG8_SA(0, 0), a2, voffA);
            PG8_WAIT_V(8); PG8_WAIT_L(0); PG8_BAR; PG8_MMA(1, 0, At, B0); PG8_MMA(1, 1, At, B1); PG8_BAR; PG8_SCHED;
            PG8_LDB(B0, 1, 0); PG8_LDB(B1, 1, 1); PG8_SCHED; PG8_LDA(At, 1, 0); PG8_STAGE(PG8_SA(0, 1), a2 + hstep, voffA);
            PG8_WAIT_V(8); PG8_WAIT_L(0); PG8_BAR; PG8_MMA(0, 0, At, B0); PG8_MMA(0, 1, At, B1); PG8_BAR; PG8_SCHED;
            PG8_LDA(At, 1, 1); PG8_STAGE(PG8_SB(1, 0), b3, voffB); PG8_STAGE(PG8_SB(1, 1), b3 + hstep, voffB); PG8_STAGE(PG8_SA(1, 0), a3, voffA);
            PG8_WAIT_V(8); PG8_WAIT_L(0); PG8_BAR; PG8_MMA(1, 0, At, B0); PG8_MMA(1, 1, At, B1); PG8_BAR; PG8_SCHED;
            } else {
            PG8_LDB(B0, 0, 0); PG8_SCHED; PG8_LDA(At, 0, 0); PG8_STAGE(PG8_SA(1, 1), a1 + hstep, voffA);
            PG8_WAIT_L(8); PG8_BAR; PG8_WAIT_L(0); PG8_MMA(0, 0, At, B0); PG8_BAR; PG8_SCHED;
            PG8_LDB(B1, 0, 1); PG8_STAGE(PG8_SB(0, 0), b2, voffB);
            PG8_BAR; PG8_WAIT_L(0); PG8_MMA(0, 1, At, B1); PG8_BAR;
            PG8_LDA(At, 0, 1); PG8_STAGE(PG8_SA(0, 0), a2, voffA);
            PG8_BAR; PG8_WAIT_L(0); PG8_MMA(1, 0, At, B0); PG8_BAR; PG8_SCHED;
            PG8_STAGE(PG8_SB(0, 1), b2 + hstep, voffB);
            PG8_WAIT_V(6); PG8_BAR; PG8_MMA(1, 1, At, B1); PG8_BAR;
            PG8_LDB(B0, 1, 0); PG8_SCHED; PG8_LDA(At, 1, 0); PG8_STAGE(PG8_SA(0, 1), a2 + hstep, voffA);
            PG8_WAIT_L(8); PG8_BAR; PG8_WAIT_L(0); PG8_MMA(0, 0, At, B0); PG8_BAR; PG8_SCHED;
            PG8_LDB(B1, 1, 1); PG8_STAGE(PG8_SB(1, 0), b3, voffB);
            PG8_BAR; PG8_WAIT_L(0); PG8_MMA(0, 1, At, B1); PG8_BAR;
            PG8_LDA(At, 1, 1); PG8_STAGE(PG8_SA(1, 0), a3, voffA);
            PG8_BAR; PG8_WAIT_L(0); PG8_MMA(1, 0, At, B0); PG8_BAR; PG8_SCHED;
            PG8_STAGE(PG8_SB(1, 1), b3 + hstep, voffB);
            PG8_WAIT_V(6); PG8_BAR; PG8_MMA(1, 1, At, B1); PG8_BAR;
            }
        }
        if constexpr (ALIGN_EPI) { if (wr == 0) PG8_BAR; }
        if constexpr (!Epi::AFTER_DRAIN) { E(acc, cur, wr, wc, fr, fq); S.done(cur); }
        if (!has_next) break;
#pragma unroll
        for (int a = 0; a < 2; ++a)
#pragma unroll
            for (int b = 0; b < 2; ++b)
#pragma unroll
                for (int m = 0; m < 4; ++m)
#pragma unroll
                    for (int n = 0; n < 2; ++n) acc[a][b][m][n] = (f32x4){0.f, 0.f, 0.f, 0.f};
        cur = nxt; cA = nA; cB = nB; ++ui;
        if constexpr (ALIGN_EPI) { if (wr == 1) PG8_BAR; }
    }
    PG8_WAIT_V(0);
    if constexpr (!ALIGN_EPI) { if (wr == 0) PG8_BAR; }
    PG8_BAR;
    if constexpr (Epi::AFTER_DRAIN) { E.fused(acc, cur, wr, wc, fr, fq, lds, wid, lane); S.done(cur); }
#undef PG8_SA
#undef PG8_SB
#undef PG8_STAGE
#undef PG8_LDA
#undef PG8_LDB
#undef PG8_MMA
#undef PG8_WAIT_V
#undef PG8_WAIT_L
#undef PG8_BAR
#undef PG8_SCHED
}
}
#define GAS __attribute__((address_space(1)))
#define LAS __attribute__((address_space(3)))
typedef unsigned short bf16;
typedef unsigned v4u __attribute__((ext_vector_type(4)));
typedef float f32x4 __attribute__((ext_vector_type(4)));
typedef short bf16x8 __attribute__((ext_vector_type(8)));
typedef GAS unsigned gu32;
typedef GAS unsigned long long gu64;
#define RLX_AGENT __ATOMIC_RELAXED, __HIP_MEMORY_SCOPE_AGENT
#define LDS_WAIT() asm volatile("s_waitcnt lgkmcnt(0)" ::: "memory")
#define VM_WAIT() asm volatile("s_waitcnt vmcnt(0)" ::: "memory")
__device__ __forceinline__ unsigned long long rt() { return __builtin_amdgcn_s_memrealtime(); }
__device__ __forceinline__ unsigned f2bf(float f) { unsigned u = __builtin_bit_cast(unsigned, f); return (u + 0x7fffu + ((u >> 16) & 1u)) >> 16; }
__device__ __forceinline__ unsigned pk2(float lo, float hi) { return f2bf(lo) | (f2bf(hi) << 16); }

#define XB_TMO      128
#define XB_XCNT(j)  (256  + 64 * (j))
#define XB_XSUB(j)  (1280 + 64 * (j))
#define XB_XGEN(j)  (2304 + 64 * (j))
#define XB_TOP      3328
#define XB_TOPGEN   3392
#define XCD_BAR_WORDS 3456
#define XB_SPIN_CAP (1u << 18)

__device__ __forceinline__ unsigned xb_ld(unsigned* p)              { return __hip_atomic_load(p, __ATOMIC_RELAXED, __HIP_MEMORY_SCOPE_AGENT); }
__device__ __forceinline__ unsigned xb_add(unsigned* p, unsigned v) { return __hip_atomic_fetch_add(p, v, __ATOMIC_RELAXED, __HIP_MEMORY_SCOPE_AGENT); }
__device__ __forceinline__ unsigned xb_xcc_id() { return (unsigned)__builtin_amdgcn_s_getreg((3 << 11) | 20) & 0xFu; }
#define XB_SPIN(cond, bar) do { unsigned _sp = 0; while (cond) { __builtin_amdgcn_s_sleep(1); \
    if ((++_sp & 255u) == 0u) { if (xb_ld(&(bar)[XB_TMO])) break; if (_sp > XB_SPIN_CAP) { atomicAdd(&(bar)[XB_TMO], 1u); break; } } } } while (0)

struct XcdBarrier {
    unsigned* bar; unsigned x;
    volatile LAS unsigned* st;
};

__device__ __forceinline__ XcdBarrier xcd_barrier_post(unsigned* bar, volatile LAS unsigned* st) {
    XcdBarrier b; b.bar = bar; b.x = xb_xcc_id(); b.st = st;
    if (threadIdx.x == 0) (void)xb_add(&bar[XB_XCNT(b.x)], 1u);
    return b;
}
__device__ __forceinline__ void xcd_barrier_complete(unsigned* bar, unsigned x, unsigned& nloc, unsigned& nx) {
    const unsigned G = gridDim.x * gridDim.y * gridDim.z;
    unsigned sum, cnt, mine, sp = 0u;
    for (;;) {
        sum = 0u; cnt = 0u; mine = 0u;
#pragma unroll
        for (unsigned j = 0; j < 16; ++j) { const unsigned c = xb_ld(&bar[XB_XCNT(j)]); sum += c; cnt += (c > 0u) ? 1u : 0u; mine = (j == x) ? c : mine; }
        if (sum == G) break;
        __builtin_amdgcn_s_sleep(1);
        if ((++sp & 255u) == 0u) { if (xb_ld(&bar[XB_TMO])) break; if (sp > XB_SPIN_CAP) { atomicAdd(&bar[XB_TMO], 1u); break; } }
    }
    nloc = mine > 0u ? mine : 1u; nx = cnt > 0u ? cnt : 1u;
}

__device__ __forceinline__ void xcd_barrier(const XcdBarrier& b) {
    asm volatile("s_waitcnt vmcnt(0)" ::: "memory");
    __syncthreads();
    if (threadIdx.x == 0) {
        unsigned* bar = b.bar;
        __builtin_amdgcn_s_waitcnt(0);
        unsigned nloc = b.st[0], nx = b.st[1];
        if (nloc == 0u) { xcd_barrier_complete(bar, b.x, nloc, nx); b.st[0] = nloc; b.st[1] = nx; }
        const unsigned old = xb_add(&bar[XB_XSUB(b.x)], 1u);
        const unsigned gen = old / nloc;
        if (old + 1u == (gen + 1u) * nloc) {
            __builtin_amdgcn_fence(__ATOMIC_RELEASE, "agent");
            asm volatile("s_waitcnt vmcnt(0)" ::: "memory");
            const unsigned og = xb_add(&bar[XB_TOP], 1u);
            const unsigned tg = og / nx;
            if (og + 1u == (tg + 1u) * nx) xb_add(&bar[XB_TOPGEN], 1u);
            else XB_SPIN(xb_ld(&bar[XB_TOPGEN]) == tg, bar);
            __builtin_amdgcn_fence(__ATOMIC_ACQUIRE, "agent");
            xb_add(&bar[XB_XGEN(b.x)], 1u);
            asm volatile("s_waitcnt vmcnt(0)" ::: "memory");
        } else {
            XB_SPIN(xb_ld(&bar[XB_XGEN(b.x)]) == gen, bar);
            __builtin_amdgcn_fence(__ATOMIC_ACQUIRE, "agent");
            asm volatile("s_waitcnt vmcnt(0)" ::: "memory");
        }
    }
    __syncthreads();
}
typedef unsigned u32x4 __attribute__((ext_vector_type(4)));
constexpr int NWAVES = 8;
constexpr int BATCH = 4, SEQ = 8192, DM = 1024, T = BATCH * SEQ;
constexpr int NPROJ = 2304, INP_FULL = 2312, DFF = 2816, NGU = 2 * DFF;
constexpr int NCHUNK = SEQ / 128;
constexpr float EPSN = 1e-6f, LOG2E = 1.4426950408889634f, QSCALE = 0.125f * 1.4426950408889634f;
constexpr int PC_Q = 0, PC_K = 512, PC_V = 640, PC_Z = 768, PC_XBC = 1280;
constexpr size_t MiB = 1u << 20;
constexpr size_t WS_CTL = 0, CTL_ZERO_BYTES = 1 * MiB;
constexpr size_t WS_MOD = 1 * MiB, WS_BIAS2 = WS_MOD + 128 * 1024, WS_WDT = WS_MOD + 256 * 1024;
constexpr size_t WS_ROPE = 2 * MiB, WS_WIN = 10 * MiB, WS_WOUT = 15 * MiB, WS_WGU = 17 * MiB, WS_WD = 28 * MiB;
constexpr size_t WS_DT = 34 * MiB, WS_ACS = 35 * MiB, WS_SSQ1 = 36 * MiB, WS_SSQ2 = 38 * MiB;
constexpr size_t WS_H = 40 * MiB;
constexpr size_t WS_PROJ = 104 * MiB;
constexpr size_t WS_XC = 248 * MiB;
constexpr size_t WS_ACT = 104 * MiB;
constexpr size_t WS_STATES = 312 * MiB;
constexpr size_t WS_PREV = 376 * MiB;
constexpr size_t WS_MIX = 408 * MiB;
constexpr size_t WS_END = 472 * MiB;
static_assert(WS_ACT + (size_t)T * DFF * 2 <= WS_STATES && WS_PROJ + (size_t)T * NPROJ * 2 <= WS_XC && WS_XC + (size_t)T * 1024 * 2 <= WS_STATES, "ws map");
constexpr int CW_BAR = 4096;
constexpr int RING_OFF = 0, RING_BYTES = 131072;
constexpr int LDSCTL_OFF = RING_BYTES, MISC_OFF = LDSCTL_OFF + 320;
constexpr int LDS_BYTES = 147456;

typedef unsigned short bf16;
typedef short s16x4 __attribute__((ext_vector_type(4)));
typedef float f32x16 __attribute__((ext_vector_type(16)));
typedef float f32x2 __attribute__((ext_vector_type(2)));
typedef unsigned u32x2 __attribute__((ext_vector_type(2)));
typedef LAS const char* lds_cptr;

struct Frame {
    LAS unsigned char* lds; volatile LAS unsigned* MISC; gu32* ctl;
    int tid, lane, wave, vcu, G;
    const float *x, *c; const int* pos;
    const float *w_ada, *b_ada, *norm1_w, *w_in, *conv_w, *conv_b, *dt_bias, *a_log, *d_skip, *sinks, *ssm_nw, *w_out, *norm2_w, *w_gu, *w_down, *wf;
    float* out;
    float *MOD, *BIAS2, *WDT, *ROPE, *DT, *ACS, *SSQ1, *SSQ2, *STATES;
    bf16 *WIN, *WOUT, *WGU, *WD, *H, *PROJ, *XC, *ACT, *PREV, *MIX;
};

__device__ __forceinline__ float wave_sum(float v) {
#pragma unroll
    for (int o = 1; o < 64; o <<= 1) v += __shfl_xor(v, o);
    return v;
}
__device__ __forceinline__ float bf2f(unsigned short h) { return __builtin_bit_cast(float, (unsigned)h << 16); }
__device__ __forceinline__ float bflo(unsigned w) { return __builtin_bit_cast(float, w << 16); }
__device__ __forceinline__ float bfhi(unsigned w) { return __builtin_bit_cast(float, w & 0xffff0000u); }
typedef float f32x2_t __attribute__((ext_vector_type(2))); typedef __bf16 bf16x2_t __attribute__((ext_vector_type(2)));
__device__ __forceinline__ unsigned cvtpk(float lo, float hi) { f32x2_t v = {lo, hi}; bf16x2_t b = __builtin_convertvector(v, bf16x2_t); return __builtin_bit_cast(unsigned, b); }
__device__ __forceinline__ float silu_f(float v) { return v * __builtin_amdgcn_rcpf(1.f + __builtin_amdgcn_exp2f(-LOG2E * v)); }
__device__ __forceinline__ float softplus_f(float v) { return v > 20.f ? v : log1pf(expf(v)); }
__device__ __forceinline__ int crow(int r, int hi) { return (r & 3) + 8 * (r >> 2) + 4 * hi; }
typedef short v4i16_t __attribute__((ext_vector_type(4)));
__device__ __forceinline__ s16x4 vtr(lds_cptr p) { return __builtin_bit_cast(s16x4, __builtin_amdgcn_ds_read_tr16_b64_v4i16((LAS v4i16_t*)p)); }
__device__ __forceinline__ bf16x8 trfrag(lds_cptr piece, int trofs) { const s16x4 lo = vtr(piece + trofs), hh = vtr(piece + trofs + 512); return (bf16x8){lo[0], lo[1], lo[2], lo[3], hh[0], hh[1], hh[2], hh[3]}; }
__device__ __forceinline__ bf16x8 ldg8(const bf16* p) { return *(const bf16x8*)p; }
#define MFMA32(a, b, c) __builtin_amdgcn_mfma_f32_32x32x16_bf16((a), (b), (c), 0, 0, 0)
__device__ __forceinline__ float swap_add(float v) { auto rr = __builtin_amdgcn_permlane32_swap(__float_as_uint(v), __float_as_uint(v), false, false); return __uint_as_float(rr[0]) + __uint_as_float(rr[1]); }
__device__ __forceinline__ float swap_max(float v) { auto rr = __builtin_amdgcn_permlane32_swap(__float_as_uint(v), __float_as_uint(v), false, false); return fmaxf(__uint_as_float(rr[0]), __uint_as_float(rr[1])); }

template <int KIND> __device__ __forceinline__ int dst_row(int n) {
    if (KIND == 0) return (n & ~0x30) | ((n & 0x10) << 1) | ((n & 0x20) >> 1);
    if (KIND == 2) { const int nn = n >= DFF ? 1 : 0, f = n - nn * DFF, pn = f >> 7, q = f & 127, wc = q >> 5, fq = (q >> 3) & 3, bj = (q >> 2) & 1, j = q & 3;
        return 256 * pn + 128 * bj + 32 * wc + 16 * nn + 4 * fq + j; }
    return n;
}
template <int KIND> __device__ __forceinline__ void p0_transpose_item(const float* W, int K, int ldw, int nblk, bf16* WT, LAS float* scr, int item, int lane) {
    const int kb = item / nblk, nb = item % nblk, k0 = 64 * kb, n0 = 32 * nb;
#pragma unroll 8
    for (int i = 0; i < 32; ++i) { const int kk = 2 * i + (lane >> 5); scr[kk * 33 + (lane & 31)] = W[(size_t)(k0 + kk) * ldw + n0 + (lane & 31)]; }
    LDS_WAIT(); asm volatile("" ::: "memory");
    const int c = lane & 7;
#pragma unroll
    for (int j = 0; j < 4; ++j) { const int n = (lane >> 3) + 8 * j; const LAS float* s = scr + (8 * c) * 33 + n;
        v4u o; o.x = pk2(s[0 * 33], s[1 * 33]); o.y = pk2(s[2 * 33], s[3 * 33]); o.z = pk2(s[4 * 33], s[5 * 33]); o.w = pk2(s[6 * 33], s[7 * 33]);
        *(GAS v4u*)(WT + (size_t)dst_row<KIND>(n0 + n) * K + k0 + 8 * c) = o; }
    LDS_WAIT(); asm volatile("" ::: "memory");
}
__device__ __forceinline__ void p0_prologue(Frame& F) {
    {
        LAS float* sc = (LAS float*)(F.lds + RING_OFF); LAS float* red = sc + 4096;
        for (int i = F.tid; i < 4096; i += 512) { const float v = F.c[i]; sc[i] = v / (1.f + expf(-v)); }
        __syncthreads();
        for (int item = blockIdx.x; item < 192; item += F.G) {
            const int col = item * 32 + (F.lane & 31), kpar = F.lane >> 5; float a0 = 0.f, a1 = 0.f, a2 = 0.f, a3 = 0.f;
#pragma unroll 8
            for (int i = 0; i < 64; ++i) { const int k = F.wave * 128 + 2 * i + kpar; const float wv = F.w_ada[(size_t)k * 6144 + col];
                a0 += sc[k] * wv; a1 += sc[1024 + k] * wv; a2 += sc[2048 + k] * wv; a3 += sc[3072 + k] * wv; }
            a0 += __shfl_xor(a0, 32); a1 += __shfl_xor(a1, 32); a2 += __shfl_xor(a2, 32); a3 += __shfl_xor(a3, 32);
            if (F.lane < 32) { red[(F.wave * 4 + 0) * 32 + F.lane] = a0; red[(F.wave * 4 + 1) * 32 + F.lane] = a1; red[(F.wave * 4 + 2) * 32 + F.lane] = a2; red[(F.wave * 4 + 3) * 32 + F.lane] = a3; }
            __syncthreads();
            if (F.tid < 128) { const int b = F.tid >> 5, cc = F.tid & 31; float s = 0.f;
#pragma unroll
                for (int w = 0; w < 8; ++w) s += red[(w * 4 + b) * 32 + cc];
                F.MOD[b * 6144 + item * 32 + cc] = s + F.b_ada[item * 32 + cc]; }
            __syncthreads();
        }
    }
    LAS float* scr = (LAS float*)(F.lds + RING_OFF + F.wave * 16384);
    const int gw = F.vcu * NWAVES + F.wave, NGW = F.G * NWAVES;
    constexpr int I_IN = 16 * 72, I_OUT = 16 * 32, I_GU = 16 * 176, I_D = 44 * 32, NITEMS = I_IN + I_OUT + I_GU + I_D;
    for (int it = gw; it < NITEMS; it += NGW) {
        int r = it;
        if (r < I_IN) { p0_transpose_item<0>(F.w_in, 1024, INP_FULL, 72, F.WIN, scr, r, F.lane); continue; } r -= I_IN;
        if (r < I_OUT) { p0_transpose_item<1>(F.w_out, 1024, 1024, 32, F.WOUT, scr, r, F.lane); continue; } r -= I_OUT;
        if (r < I_GU) { p0_transpose_item<2>(F.w_gu, 1024, NGU, 176, F.WGU, scr, r, F.lane); continue; } r -= I_GU;
        p0_transpose_item<1>(F.w_down, DFF, 1024, 32, F.WD, scr, r, F.lane);
    }
    const int gtid = F.vcu * 512 + F.tid, NGT = F.G * 512;
    for (int idx = gtid; idx < 8192; idx += NGT) { const int j = idx >> 10, k = idx & 1023; F.WDT[idx] = F.w_in[(size_t)k * INP_FULL + 2304 + j]; }
    for (int idx = gtid; idx < T * 32; idx += NGT) { const int t = idx >> 5, i = idx & 31;
        const float inv = powf(10000.f, -(float)i / 32.f), ang = (float)F.pos[t] * inv; F.ROPE[(size_t)t * 64 + i] = cosf(ang); F.ROPE[(size_t)t * 64 + 32 + i] = sinf(ang); }
}
__device__ __forceinline__ void p0b_rows(Frame& F) {
    const int gw = F.vcu * NWAVES + F.wave, NGW = F.G * NWAVES;
    {
        f32x4 sh[4][2][2];
#pragma unroll
        for (int b = 0; b < 4; ++b)
#pragma unroll
            for (int j = 0; j < 2; ++j)
#pragma unroll
                for (int q = 0; q < 2; ++q) sh[b][j][q] = *(const f32x4*)(F.MOD + b * 6144 + 3072 + j * 512 + F.lane * 8 + q * 4);
        for (int p = gw; p < NGU; p += NGW) {
            float a[4] = {0.f, 0.f, 0.f, 0.f};
#pragma unroll
            for (int j = 0; j < 2; ++j) { const v4u w = *(const v4u*)(F.WGU + (size_t)p * 1024 + j * 512 + F.lane * 8);
                const f32x4 w0 = (f32x4){bflo(w.x), bfhi(w.x), bflo(w.y), bfhi(w.y)}, w1 = (f32x4){bflo(w.z), bfhi(w.z), bflo(w.w), bfhi(w.w)};
#pragma unroll
                for (int b = 0; b < 4; ++b) { const f32x4 t0 = sh[b][j][0] * w0, t1 = sh[b][j][1] * w1; a[b] += (t0[0] + t0[1]) + (t0[2] + t0[3]) + (t1[0] + t1[1]) + (t1[2] + t1[3]); } }
#pragma unroll
            for (int b = 0; b < 4; ++b) a[b] = wave_sum(a[b]);
            if (F.lane < 4) F.BIAS2[F.lane * NGU + p] = F.lane == 0 ? a[0] : F.lane == 1 ? a[1] : F.lane == 2 ? a[2] : a[3];
        }
    }
    for (int rb = gw; rb < T / 16; rb += NGW) {
        const int r0 = rb * 16, b = r0 / SEQ; const float* mb = F.MOD + b * 6144;
        f32x4 a1[4], sh[4];
#pragma unroll
        for (int j = 0; j < 4; ++j) { const int col = 4 * F.lane + 256 * j; a1[j] = *(const f32x4*)(F.norm1_w + col) * (*(const f32x4*)(mb + 1024 + col) + 1.0f); sh[j] = *(const f32x4*)(mb + col); }
        for (int r = r0; r < r0 + 16; ++r) {
            const GAS f32x4* xr = (const GAS f32x4*)(F.x + (size_t)r * DM) + F.lane;
            f32x4 v[4]; float s = 0.f;
#pragma unroll
            for (int j = 0; j < 4; ++j) { v[j] = xr[64 * j]; s += (v[j][0] * v[j][0] + v[j][1] * v[j][1]) + (v[j][2] * v[j][2] + v[j][3] * v[j][3]); }
            const float rstd = 1.0f / sqrtf(wave_sum(s) * (1.f / DM) + EPSN);
            GAS unsigned long long* o8 = (GAS unsigned long long*)(F.H + (size_t)r * DM) + F.lane;
#pragma unroll
            for (int j = 0; j < 4; ++j) { v[j] = v[j] * rstd * a1[j] + sh[j]; o8[64 * j] = (unsigned long long)cvtpk(v[j][0], v[j][1]) | ((unsigned long long)cvtpk(v[j][2], v[j][3]) << 32); }
            float d[8];
#pragma unroll
            for (int jj = 0; jj < 8; ++jj) { float acc = 0.f;
#pragma unroll
                for (int j = 0; j < 4; ++j) { const f32x4 w = *(const f32x4*)(F.WDT + jj * 1024 + 4 * F.lane + 256 * j); const f32x4 t = v[j] * w; acc += (t[0] + t[1]) + (t[2] + t[3]); }
                d[jj] = wave_sum(acc); }
            if (F.lane < 8) { float dv = d[0];
#pragma unroll
                for (int jj = 1; jj < 8; ++jj) dv = (F.lane == jj) ? d[jj] : dv;
                F.DT[(size_t)r * 8 + F.lane] = softplus_f(dv + F.dt_bias[F.lane]); }
        }
    }
}

__device__ __forceinline__ void attn_unit(Frame& F, int b, int qb, int g) {
    const int tid = F.tid, lane = F.lane, wave = F.wave, r32 = lane & 31, hi = lane >> 5;
    const size_t rowb = (size_t)b * SEQ; const int s0 = qb * 128;
    const int trofs = ((lane >> 4) & 1) * 32 + (lane & 3) * 8 + (4 * hi + ((lane & 15) >> 2)) * 64;
#pragma unroll
    for (int i = 0; i < 4; ++i) { const int idx = tid + 512 * i, key = idx >> 3, ch = idx & 7; int kp = s0 - 128 + key; kp = kp < 0 ? 0 : kp;
        const v4u v = *(const v4u*)(F.PROJ + (rowb + kp) * NPROJ + PC_V + g * 64 + ch * 8);
        const int slot = key >> 6, kk = key & 63, off = slot * 8192 + ((ch >> 2) * 4 + (kk >> 4)) * 1024 + (kk & 15) * 64 + (ch & 3) * 16;
        *(LAS v4u*)(F.lds + off) = v; }
    __syncthreads();
    const int hq = 4 * g + (wave >> 1); const float sink2 = F.sinks[hq] * LOG2E;
    for (int sb = 0; sb < 2; ++sb) {
        const int q0 = 64 * (wave & 1) + 32 * sb, tile0 = q0 >> 6;
        const bf16* qrow = F.PROJ + (rowb + s0 + q0 + r32) * NPROJ + PC_Q + hq * 64 + 8 * hi;
        bf16x8 qf[4];
#pragma unroll
        for (int ks = 0; ks < 4; ++ks) qf[ks] = ldg8(qrow + 16 * ks);
        f32x16 p[6];
#pragma unroll
        for (int ti = 0; ti < 6; ++ti) { int kp = s0 - 128 + 64 * (tile0 + (ti >> 1)) + 32 * (ti & 1) + r32; kp = kp < 0 ? 0 : kp;
            const bf16* krow = F.PROJ + (rowb + kp) * NPROJ + PC_K + g * 64 + 8 * hi; f32x16 a = {};
#pragma unroll
            for (int ks = 0; ks < 4; ++ks) a = MFMA32(ldg8(krow + 16 * ks), qf[ks], a);
            p[ti] = a; }
        const int qpos = s0 + q0 + r32; float m = sink2;
#pragma unroll
        for (int ti = 0; ti < 6; ++ti)
#pragma unroll
            for (int r = 0; r < 16; ++r) { const int kp = s0 - 128 + 64 * (tile0 + (ti >> 1)) + 32 * (ti & 1) + crow(r, hi), d = qpos - kp;
                const bool ok = (d >= 0) && (d < 128) && (kp >= 0); const float v = ok ? p[ti][r] : -INFINITY; p[ti][r] = v; m = fmaxf(m, v); }
        m = swap_max(m);
        float sum = 0.f;
#pragma unroll
        for (int ti = 0; ti < 6; ++ti)
#pragma unroll
            for (int r = 0; r < 16; ++r) { const float e = __builtin_amdgcn_exp2f(p[ti][r] - m); p[ti][r] = e; sum += e; }
        sum = swap_add(sum);
        const float inv = 1.0f / (sum + __builtin_amdgcn_exp2f(sink2 - m));
        f32x16 o[2]; o[0] = f32x16{}; o[1] = f32x16{};
#pragma unroll
        for (int ti = 0; ti < 6; ++ti) {
            u32x4 w0 = (u32x4){cvtpk(p[ti][0], p[ti][1]), cvtpk(p[ti][2], p[ti][3]), cvtpk(p[ti][4], p[ti][5]), cvtpk(p[ti][6], p[ti][7])};
            u32x4 w1 = (u32x4){cvtpk(p[ti][8], p[ti][9]), cvtpk(p[ti][10], p[ti][11]), cvtpk(p[ti][12], p[ti][13]), cvtpk(p[ti][14], p[ti][15])};
            const lds_cptr slot = (lds_cptr)F.lds + (tile0 + (ti >> 1)) * 8192;
#pragma unroll
            for (int kk = 0; kk < 2; ++kk) { const int rg = 2 * (ti & 1) + kk; const bf16x8 pb = __builtin_bit_cast(bf16x8, kk == 0 ? w0 : w1);
#pragma unroll
                for (int dt = 0; dt < 2; ++dt) o[dt] = MFMA32(trfrag(slot + (dt * 4 + rg) * 1024, trofs), pb, o[dt]); }
        }
        bf16* orow = F.MIX + (rowb + s0 + q0 + r32) * DM + hq * 64 + 4 * hi;
#pragma unroll
        for (int dt = 0; dt < 2; ++dt)
#pragma unroll
            for (int rr = 0; rr < 4; ++rr) { u32x2 w; w.x = cvtpk(o[dt][4 * rr] * inv, o[dt][4 * rr + 1] * inv); w.y = cvtpk(o[dt][4 * rr + 2] * inv, o[dt][4 * rr + 3] * inv);
                *(u32x2*)(orow + 32 * dt + 8 * rr) = w; }
    }
    __syncthreads();
}

__device__ __forceinline__ void ssdA_unit(Frame& F, int b, int c, int g) {
    const int tid = F.tid, lane = F.lane, wave = F.wave, r32 = lane & 31, hi = lane >> 5;
    const size_t t0 = (size_t)b * SEQ + (size_t)c * 128;
    LAS float* acs = (LAS float*)(F.lds + 98304); LAS float* dts = (LAS float*)(F.lds + 100352); LAS float* wtot = (LAS float*)(F.lds + 102400);
    {
        const int hl = tid >> 7, l = tid & 127, h = 4 * g + hl;
        const float dtv = F.DT[(t0 + l) * 8 + h]; float v = dtv * (-expf(F.a_log[h]));
#pragma unroll
        for (int o = 1; o < 64; o <<= 1) { const float t = __shfl_up(v, o); if (lane >= o) v += t; }
        if (lane == 63) wtot[wave] = v;
        dts[hl * 128 + l] = dtv;
        __syncthreads();
        if (wave & 1) v += wtot[wave - 1];
        acs[hl * 128 + l] = v; F.ACS[(t0 + l) * 8 + h] = v;
        __syncthreads();
    }
    {
        const int strip = lane, l0 = 16 * wave;
        const int xch = strip < 32 ? g * 256 + 8 * strip : strip < 48 ? 512 + g * 128 + 8 * (strip - 32) : 768 + g * 128 + 8 * (strip - 48);
        float w[4][8], bias[8];
#pragma unroll
        for (int k = 0; k < 4; ++k) { const f32x4 a = *(const f32x4*)(F.conv_w + k * 1024 + xch), bq = *(const f32x4*)(F.conv_w + k * 1024 + xch + 4);
            w[k][0] = a[0]; w[k][1] = a[1]; w[k][2] = a[2]; w[k][3] = a[3]; w[k][4] = bq[0]; w[k][5] = bq[1]; w[k][6] = bq[2]; w[k][7] = bq[3]; }
        { const f32x4 a = *(const f32x4*)(F.conv_b + xch), bq = *(const f32x4*)(F.conv_b + xch + 4); bias[0] = a[0]; bias[1] = a[1]; bias[2] = a[2]; bias[3] = a[3]; bias[4] = bq[0]; bias[5] = bq[1]; bias[6] = bq[2]; bias[7] = bq[3]; }
        float xw[3][8];
#pragma unroll
        for (int i = 0; i < 3; ++i) { const int l = l0 - 3 + i; const bool ok = (c > 0) || (l >= 0);
            v4u v = (v4u){0u, 0u, 0u, 0u}; if (ok) v = *(const v4u*)(F.PROJ + (size_t)((long)t0 + l) * NPROJ + PC_XBC + xch);
            xw[i][0] = bflo(v.x); xw[i][1] = bfhi(v.x); xw[i][2] = bflo(v.y); xw[i][3] = bfhi(v.y); xw[i][4] = bflo(v.z); xw[i][5] = bfhi(v.z); xw[i][6] = bflo(v.w); xw[i][7] = bfhi(v.w); }
        const int hl = strip >> 3;
        const float aend = acs[(hl & 3) * 128 + 127];
#pragma unroll 4
        for (int i = 0; i < 16; ++i) { const int l = l0 + i;
            const v4u v = *(const v4u*)(F.PROJ + (t0 + l) * NPROJ + PC_XBC + xch);
            float xc[8] = {bflo(v.x), bfhi(v.x), bflo(v.y), bfhi(v.y), bflo(v.z), bfhi(v.z), bflo(v.w), bfhi(v.w)}; float o[8];
#pragma unroll
            for (int e = 0; e < 8; ++e) { o[e] = silu_f(bias[e] + w[0][e] * xw[0][e] + w[1][e] * xw[1][e] + w[2][e] * xw[2][e] + w[3][e] * xc[e]); xw[0][e] = xw[1][e]; xw[1][e] = xw[2][e]; xw[2][e] = xc[e]; }
            *(v4u*)(F.XC + (t0 + l) * 1024 + xch) = (v4u){cvtpk(o[0], o[1]), cvtpk(o[2], o[3]), cvtpk(o[4], o[5]), cvtpk(o[6], o[7])};
            if (strip < 32) { const float sc = dts[hl * 128 + l] * __builtin_amdgcn_exp2f((aend - acs[hl * 128 + l]) * LOG2E); const int p0 = 8 * (strip & 7);
                *(LAS v4u*)(F.lds + hl * 16384 + ((p0 >> 5) * 8 + (l >> 4)) * 1024 + (l & 15) * 64 + (p0 & 31) * 2) = (v4u){cvtpk(o[0] * sc, o[1] * sc), cvtpk(o[2] * sc, o[3] * sc), cvtpk(o[4] * sc, o[5] * sc), cvtpk(o[6] * sc, o[7] * sc)}; }
            else if (strip < 48) { const int n0 = 8 * (strip - 32);
                *(LAS v4u*)(F.lds + 65536 + ((n0 >> 5) * 8 + (l >> 4)) * 1024 + (l & 15) * 64 + (n0 & 31) * 2) = (v4u){cvtpk(o[0], o[1]), cvtpk(o[2], o[3]), cvtpk(o[4], o[5]), cvtpk(o[6], o[7])}; }
        }
        __syncthreads();
    }
    {
        const int j = wave >> 1, pt = wave & 1, trofs = ((lane >> 4) & 1) * 32 + (lane & 3) * 8 + (4 * hi + ((lane & 15) >> 2)) * 64;
        f32x16 acc[4]; acc[0] = f32x16{}; acc[1] = f32x16{}; acc[2] = f32x16{}; acc[3] = f32x16{};
        const lds_cptr Xb = (lds_cptr)F.lds + j * 16384 + pt * 8192, Bb = (lds_cptr)F.lds + 65536;
#pragma unroll
        for (int ks = 0; ks < 8; ++ks) { const bf16x8 a = trfrag(Xb + ks * 1024, trofs);
#pragma unroll
            for (int nt = 0; nt < 4; ++nt) acc[nt] = MFMA32(a, trfrag(Bb + (nt * 8 + ks) * 1024, trofs), acc[nt]); }
        float* st = F.STATES + ((((size_t)b * NCHUNK + c) * 8 + 4 * g + j) * 64 + 32 * pt) * 128 + r32;
#pragma unroll
        for (int nt = 0; nt < 4; ++nt)
#pragma unroll
            for (int r = 0; r < 16; ++r) st[(size_t)crow(r, hi) * 128 + 32 * nt] = acc[nt][r];
    }
    __syncthreads();
}

__device__ __forceinline__ void scan_phase(Frame& F) {
    const int gtid = F.vcu * 512 + F.tid, NGT = F.G * 512;
    for (int e = gtid; e < BATCH * 8 * 64 * 64; e += NGT) {
        const int n2 = e & 63, p = (e >> 6) & 63, h = (e >> 12) & 7, b = e >> 15;
        f32x2 st = (f32x2){0.f, 0.f};
#pragma unroll 8
        for (int c = 0; c < NCHUNK; ++c) {
            const size_t idx = ((((size_t)b * NCHUNK + c) * 8 + h) * 64 + p) * 128 + 2 * n2;
            *(unsigned*)(F.PREV + idx) = cvtpk(st[0], st[1]);
            const float dec = __builtin_amdgcn_exp2f(F.ACS[((size_t)b * SEQ + c * 128 + 127) * 8 + h] * LOG2E);
            const f32x2 s = *(const f32x2*)(F.STATES + idx); st = st * dec + s;
        }
    }
}

__device__ __forceinline__ void ssdB_unit(Frame& F, int b, int c, int g) {
    const int tid = F.tid, lane = F.lane, wave = F.wave, r32 = lane & 31, hi = lane >> 5;
    const size_t t0 = (size_t)b * SEQ + (size_t)c * 128;
    LAS float* acs = (LAS float*)(F.lds + 65536); LAS float* part = (LAS float*)(F.lds + 67584);
    { const int hl = tid >> 7, l = tid & 127; acs[hl * 128 + l] = F.ACS[(t0 + l) * 8 + 4 * g + hl]; }
    {
        const int strip = tid & 31, lg = tid >> 5, hl = strip >> 3, p0 = 8 * (strip & 7);
#pragma unroll
        for (int i = 0; i < 8; ++i) { const int l = 8 * lg + i; const v4u v = *(const v4u*)(F.XC + (t0 + l) * 1024 + g * 256 + 8 * strip); const float d = F.DT[(t0 + l) * 8 + 4 * g + hl];
            *(LAS v4u*)(F.lds + hl * 16384 + ((p0 >> 5) * 8 + (l >> 4)) * 1024 + (l & 15) * 64 + (p0 & 31) * 2) =
                (v4u){cvtpk(bflo(v.x) * d, bfhi(v.x) * d), cvtpk(bflo(v.y) * d, bfhi(v.y) * d), cvtpk(bflo(v.z) * d, bfhi(v.z) * d), cvtpk(bflo(v.w) * d, bfhi(v.w) * d)}; }
    }
    __syncthreads();
    const int j = wave >> 1, h = 4 * g + j, trofs = ((lane >> 4) & 1) * 32 + (lane & 3) * 8 + (4 * hi + ((lane & 15) >> 2)) * 64;
    const lds_cptr Xb = (lds_cptr)F.lds + j * 16384;
    const float dsk = F.d_skip[h];
    for (int li = 0; li < 2; ++li) {
        const int lt = (wave & 1) ? (li == 0 ? 1 : 2) : (li == 0 ? 0 : 3);
        const int lcol = 32 * lt + r32;
        bf16x8 cf[8];
        { const bf16* crowp = F.XC + (t0 + lcol) * 1024 + 768 + g * 128 + 8 * hi;
#pragma unroll
          for (int ks = 0; ks < 8; ++ks) cf[ks] = ldg8(crowp + 16 * ks); }
        const float acs_l = acs[j * 128 + lcol], dinv = dsk / F.DT[(t0 + lcol) * 8 + h];
        f32x16 yT[2]; yT[0] = f32x16{}; yT[1] = f32x16{};
        for (int st = 0; st <= lt; ++st) {
            const bf16* brow = F.XC + (t0 + 32 * st + r32) * 1024 + 512 + g * 128 + 8 * hi;
            f32x16 S = {};
#pragma unroll
            for (int ks = 0; ks < 8; ++ks) S = MFMA32(ldg8(brow + 16 * ks), cf[ks], S);
#pragma unroll
            for (int r = 0; r < 16; ++r) { const int s = 32 * st + crow(r, hi); const float as = acs[j * 128 + s];
                float v = (s <= lcol) ? S[r] * __builtin_amdgcn_exp2f((acs_l - as) * LOG2E) : 0.f; if (s == lcol) v += dinv; S[r] = v; }
            const u32x4 w0 = (u32x4){cvtpk(S[0], S[1]), cvtpk(S[2], S[3]), cvtpk(S[4], S[5]), cvtpk(S[6], S[7])};
            const u32x4 w1 = (u32x4){cvtpk(S[8], S[9]), cvtpk(S[10], S[11]), cvtpk(S[12], S[13]), cvtpk(S[14], S[15])};
#pragma unroll
            for (int kk = 0; kk < 2; ++kk) { const bf16x8 pb = __builtin_bit_cast(bf16x8, kk == 0 ? w0 : w1);
#pragma unroll
                for (int pt = 0; pt < 2; ++pt) yT[pt] = MFMA32(trfrag(Xb + (pt * 8 + 2 * st + kk) * 1024, trofs), pb, yT[pt]); }
        }
        f32x16 yo[2]; yo[0] = f32x16{}; yo[1] = f32x16{};
        { const bf16* pr = F.PREV + ((((size_t)b * NCHUNK + c) * 8 + h) * 64 + r32) * 128 + 8 * hi;
#pragma unroll
          for (int pt = 0; pt < 2; ++pt)
#pragma unroll
              for (int ks = 0; ks < 8; ++ks) yo[pt] = MFMA32(ldg8(pr + (size_t)pt * 32 * 128 + 16 * ks), cf[ks], yo[pt]); }
        const float e_l = __builtin_amdgcn_exp2f(acs_l * LOG2E);
        const bf16* zrow = F.PROJ + (t0 + lcol) * NPROJ + PC_Z + h * 64 + 4 * hi;
        float ss = 0.f;
#pragma unroll
        for (int pt = 0; pt < 2; ++pt)
#pragma unroll
            for (int rr = 0; rr < 4; ++rr) { const u32x2 z = *(const u32x2*)(zrow + 32 * pt + 8 * rr);
                const float zz[4] = {bflo(z.x), bfhi(z.x), bflo(z.y), bfhi(z.y)};
#pragma unroll
                for (int q = 0; q < 4; ++q) { const float v = (yT[pt][4 * rr + q] + e_l * yo[pt][4 * rr + q]) * zz[q]; yT[pt][4 * rr + q] = v; ss += v * v; } }
        ss = swap_add(ss);
        if (hi == 0) part[(li * 4 + j) * 128 + lcol] = ss;
        __syncthreads();
        const float tot = (part[(li * 4 + 0) * 128 + lcol] + part[(li * 4 + 1) * 128 + lcol]) + (part[(li * 4 + 2) * 128 + lcol] + part[(li * 4 + 3) * 128 + lcol]);
        const float rstd = __builtin_amdgcn_rsqf(tot * (1.0f / 256.0f) + EPSN);
        bf16* orow = F.MIX + (t0 + lcol) * DM + 512 + h * 64 + 4 * hi; const float* nw = F.ssm_nw + h * 64 + 4 * hi;
#pragma unroll
        for (int pt = 0; pt < 2; ++pt)
#pragma unroll
            for (int rr = 0; rr < 4; ++rr) { const f32x4 wv = *(const f32x4*)(nw + 32 * pt + 8 * rr); u32x2 w;
                w.x = cvtpk(yT[pt][4 * rr] * rstd * wv[0], yT[pt][4 * rr + 1] * rstd * wv[1]); w.y = cvtpk(yT[pt][4 * rr + 2] * rstd * wv[2], yT[pt][4 * rr + 3] * rstd * wv[3]);
                *(u32x2*)(orow + 32 * pt + 8 * rr) = w; }
    }
    __syncthreads();
}

__device__ __forceinline__ void final_phase(Frame& F) {
    const int gw = F.vcu * NWAVES + F.wave, NGW = F.G * NWAVES;
    f32x4 wv[4];
#pragma unroll
    for (int j = 0; j < 4; ++j) wv[j] = *(const f32x4*)(F.wf + 4 * F.lane + 256 * j);
    for (int rb = gw; rb < T / 16; rb += NGW)
        for (int r = rb * 16; r < rb * 16 + 16; ++r) {
            float s = F.SSQ2[(size_t)r * 16 + (F.lane & 15)];
            s += __shfl_xor(s, 1); s += __shfl_xor(s, 2); s += __shfl_xor(s, 4); s += __shfl_xor(s, 8);
            const float rstd = 1.0f / sqrtf(s * (1.f / DM) + EPSN);
            GAS f32x4* xr = (GAS f32x4*)(F.out + (size_t)r * DM) + F.lane;
#pragma unroll
            for (int j = 0; j < 4; ++j) xr[64 * j] = xr[64 * j] * rstd * wv[j];
        }
}
#ifndef MK_N_LAUNCHES
#define MK_N_LAUNCHES 1
#endif
constexpr int N_PHASES = 10;
constexpr int N_LAUNCHES = MK_N_LAUNCHES;
struct Args { const void* in[19]; float* out; unsigned char* ws; int ph_lo, ph_hi; };
__global__ void __launch_bounds__(NWAVES * 64, 2) fwd_kernel(Args args) {
    extern __shared__ __attribute__((aligned(16))) unsigned char lds[];
    Frame F;
    F.lds = (LAS unsigned char*)lds;
    F.MISC = (volatile LAS unsigned*)(F.lds + MISC_OFF);
    F.tid = threadIdx.x; F.lane = F.tid & 63; F.wave = __builtin_amdgcn_readfirstlane(F.tid >> 6);
    F.G = gridDim.x; { const int bx = blockIdx.x; F.vcu = (F.G % 8 == 0) ? (bx % 8) * (F.G / 8) + bx / 8 : bx; }
    unsigned char* ws = args.ws;
    F.ctl = (gu32*)(ws + WS_CTL);
    F.x = (const float*)args.in[0]; F.c = (const float*)args.in[1]; F.pos = (const int*)args.in[2];
    F.w_ada = (const float*)args.in[3]; F.b_ada = (const float*)args.in[4]; F.norm1_w = (const float*)args.in[5]; F.w_in = (const float*)args.in[6];
    F.conv_w = (const float*)args.in[7]; F.conv_b = (const float*)args.in[8]; F.dt_bias = (const float*)args.in[9]; F.a_log = (const float*)args.in[10];
    F.d_skip = (const float*)args.in[11]; F.sinks = (const float*)args.in[12]; F.ssm_nw = (const float*)args.in[13]; F.w_out = (const float*)args.in[14];
    F.norm2_w = (const float*)args.in[15]; F.w_gu = (const float*)args.in[16]; F.w_down = (const float*)args.in[17]; F.wf = (const float*)args.in[18];
    F.out = args.out;
    F.MOD = (float*)(ws + WS_MOD); F.BIAS2 = (float*)(ws + WS_BIAS2); F.WDT = (float*)(ws + WS_WDT); F.ROPE = (float*)(ws + WS_ROPE);
    F.DT = (float*)(ws + WS_DT); F.ACS = (float*)(ws + WS_ACS); F.SSQ1 = (float*)(ws + WS_SSQ1); F.SSQ2 = (float*)(ws + WS_SSQ2); F.STATES = (float*)(ws + WS_STATES);
    F.WIN = (bf16*)(ws + WS_WIN); F.WOUT = (bf16*)(ws + WS_WOUT); F.WGU = (bf16*)(ws + WS_WGU); F.WD = (bf16*)(ws + WS_WD);
    F.H = (bf16*)(ws + WS_H); F.PROJ = (bf16*)(ws + WS_PROJ); F.XC = (bf16*)(ws + WS_XC); F.ACT = (bf16*)(ws + WS_ACT); F.PREV = (bf16*)(ws + WS_PREV); F.MIX = (bf16*)(ws + WS_MIX);
    for (int u = F.tid; u < (LDS_BYTES - LDSCTL_OFF) / 4; u += NWAVES * 64) ((LAS unsigned*)(F.lds + LDSCTL_OFF))[u] = 0u;
    __syncthreads();
    XcdBarrier bar; bar.bar = (unsigned*)(F.ctl + CW_BAR); bar.x = 0; bar.st = nullptr;
    if (N_LAUNCHES == 1) bar = xcd_barrier_post((unsigned*)(F.ctl + CW_BAR), F.MISC + 8);
    const int lo = args.ph_lo, hi = args.ph_hi;
#define IN(k) (lo <= (k) && (k) < hi)
#define SEAM(k) do { if (IN(k) && IN((k) + 1)) xcd_barrier(bar); } while (0)

    if (IN(0)) { p0_prologue(F); __syncthreads(); } SEAM(0);
    if (IN(1)) { p0b_rows(F); } SEAM(1);
    if (IN(2)) {
        pg8::Gemm g{F.H, F.WIN, T, NPROJ, DM}; pg8::StaticOrder S; S.init(T, NPROJ, F.G, (int)blockIdx.x);
        pg8::EpiInProj E{F.PROJ, F.ROPE, QSCALE};
        pg8::gemm_phase<pg8::EpiInProj, pg8::StaticOrder, true, true>(F.lds + RING_OFF, g, S, E);
    } SEAM(2);
    if (IN(3)) {
        for (int i = F.vcu; i < BATCH * NCHUNK * 2; i += F.G) ssdA_unit(F, i >> 7, (i & 127) >> 1, i & 1);
        for (int i = F.vcu; i < BATCH * NCHUNK * 2; i += F.G) attn_unit(F, i >> 7, (i & 127) >> 1, i & 1);
    } SEAM(3);
    if (IN(4)) { scan_phase(F); } SEAM(4);
    if (IN(5)) { for (int i = F.vcu; i < BATCH * NCHUNK * 2; i += F.G) ssdB_unit(F, i >> 7, (i & 127) >> 1, i & 1); } SEAM(5);
    if (IN(6)) {
        pg8::Gemm g{F.MIX, F.WOUT, T, DM, DM}; pg8::StaticOrder S; S.init(T, DM, F.G, (int)blockIdx.x);
        pg8::EpiRes<true> E{F.x, F.out, F.MOD, 2048, F.norm2_w, F.H, F.SSQ1};
        pg8::gemm_phase<pg8::EpiRes<true>, pg8::StaticOrder, true, true>(F.lds + RING_OFF, g, S, E);
    } SEAM(6);
    if (IN(7)) {
        pg8::Gemm g{F.H, F.WGU, T, NGU, DM}; pg8::StaticOrder S; S.init(T, NGU, F.G, (int)blockIdx.x);
        pg8::EpiGU E{F.ACT, F.SSQ1, F.BIAS2};
        pg8::gemm_phase<pg8::EpiGU, pg8::StaticOrder, true, true>(F.lds + RING_OFF, g, S, E);
    } SEAM(7);
    if (IN(8)) {
        pg8::Gemm g{F.ACT, F.WD, T, DM, DFF}; pg8::StaticOrder S; S.init(T, DM, F.G, (int)blockIdx.x);
        pg8::EpiRes<false> E{F.out, F.out, F.MOD, 5120, nullptr, nullptr, F.SSQ2};
        pg8::gemm_phase<pg8::EpiRes<false>, pg8::StaticOrder, true, true>(F.lds + RING_OFF, g, S, E);
    } SEAM(8);
    if (IN(9)) { final_phase(F); }
#undef IN
#undef SEAM
}

static int g_grid = 0;
static void launch_fwd(void* const* d_in, void* d_out, void* d_ws, hipStream_t stream) {
    if (g_grid == 0) {
        int dev = 0, cus = 0, per_cu = 0;
        if (hipGetDevice(&dev) != hipSuccess || hipDeviceGetAttribute(&cus, hipDeviceAttributeMultiprocessorCount, dev) != hipSuccess) { fprintf(stderr, "kernel_launch: device query failed\n"); g_grid = -1; return; }
        if (hipFuncSetAttribute((const void*)fwd_kernel, hipFuncAttributeMaxDynamicSharedMemorySize, LDS_BYTES) != hipSuccess) { fprintf(stderr, "kernel_launch: hipFuncSetAttribute failed\n"); g_grid = -1; return; }
        if (hipOccupancyMaxActiveBlocksPerMultiprocessor(&per_cu, (const void*)fwd_kernel, NWAVES * 64, LDS_BYTES) != hipSuccess) per_cu = 0;
        (void)hipGetLastError();
        if (per_cu < 1) { fprintf(stderr, "kernel_launch: occupancy query reports %d blocks per CU\n", per_cu); g_grid = -1; return; }
        g_grid = cus;
    }
    if (g_grid < 0) return;
    if (N_LAUNCHES == 1) (void)hipMemsetAsync((char*)d_ws + WS_CTL, 0, CTL_ZERO_BYTES, stream);
    Args a{};
    for (int i = 0; i < 19; ++i) a.in[i] = d_in[i];
    a.out = (float*)d_out; a.ws = (unsigned char*)d_ws;
    for (int li = 0; li < N_LAUNCHES; ++li) {
        a.ph_lo = (N_LAUNCHES == 1) ? 0 : li; a.ph_hi = (N_LAUNCHES == 1) ? N_PHASES : li + 1;
        hipLaunchKernelGGL(fwd_kernel, dim3(g_grid), dim3(NWAVES * 64), LDS_BYTES, stream, a);
        const hipError_t le = hipPeekAtLastError();
        if (le != hipSuccess) { fprintf(stderr, "kernel_launch: launch %d failed: %s\n", li, hipGetErrorName(le)); break; }
    }
}
extern "C" void kernel_launch(void* const* d_in, const int* in_sizes, int n_in, void* d_out, int out_size, void* d_ws, size_t ws_size, hipStream_t stream) {
    (void)in_sizes; (void)n_in; (void)out_size; (void)ws_size;
    launch_fwd(d_in, d_out, d_ws, stream);
}
```
